# Optimizing an MI355X kernel written in HIP

```python
import jax, jax.numpy as jnp
from jax import lax
import numpy as np

D_MODEL = 1024
BATCH = 8
SEQ = 2048
DEPTH = 1

MIX_WIDTH = D_MODEL
CONV_WIDTH = MIX_WIDTH // 2
CONV_HEADS = 8
CONV_KERNEL = 31
POOL_WIDTH = MIX_WIDTH - CONV_WIDTH
POOL_WINDOWS = (2, 4, 8, 16)
POOL_GROUPS = len(POOL_WINDOWS)
POOL_GROUP_DIM = POOL_WIDTH // POOL_GROUPS
IN_WIDTH = 2 * CONV_WIDTH + POOL_WIDTH
D_FF = ((8 * D_MODEL // 3 + 255) // 256) * 256
N_MOD = 6
EPS = 1e-6

kernel_name = "hybrid_conv_pool_adaln_block"


def rmsnorm(x, g):
    xf = x.astype(jnp.float32)
    y = xf * lax.rsqrt(jnp.mean(xf * xf, axis=-1, keepdims=True) + EPS)
    return (y * g.astype(jnp.float32)).astype(x.dtype)


def layernorm(x, g, b):
    xf = x.astype(jnp.float32)
    mu = jnp.mean(xf, axis=-1, keepdims=True)
    var = jnp.mean(jnp.square(xf - mu), axis=-1, keepdims=True)
    y = (xf - mu) * lax.rsqrt(var + EPS)
    return (y * g.astype(jnp.float32) + b.astype(jnp.float32)).astype(x.dtype)


def conv_mixer(u, dw_w, dw_b, ln_g, ln_b, w_pw):
    a, g = jnp.split(u, 2, axis=-1)
    h = a * jax.nn.sigmoid(g)
    h = lax.conv_general_dilated(
        h, dw_w[:, None, :].astype(h.dtype), window_strides=(1,),
        padding=[(CONV_KERNEL - 1, 0)],
        dimension_numbers=('NWC', 'WIO', 'NWC'),
        feature_group_count=CONV_WIDTH) + dw_b
    h = layernorm(h, ln_g, ln_b)
    h = jax.nn.silu(h)
    return h @ w_pw


def pool_mixer(v, w_group, scale):
    B, S, _ = v.shape
    vg = v.astype(jnp.float32).reshape(B, S, POOL_GROUPS, POOL_GROUP_DIM)
    cs = jnp.cumsum(vg, axis=1)
    t = jnp.arange(S)
    pooled = []
    for gi, w in enumerate(POOL_WINDOWS):
        c_g = cs[:, :, gi]
        shifted = jnp.pad(c_g, ((0, 0), (w, 0), (0, 0)))[:, :S]
        cnt = jnp.minimum(t + 1, w).astype(jnp.float32)
        pooled.append((c_g - shifted) / cnt[None, :, None])
    p = (jnp.stack(pooled, axis=2) - vg).astype(v.dtype)
    y = jnp.einsum('bsgc,gcd->bsgd', p, w_group).reshape(B, S, POOL_WIDTH)
    return y * scale


def setup_inputs(seed: int = 0) -> dict:
    key = jax.random.key(seed)
    ks = jax.random.split(key, 20)
    L, D = DEPTH, D_MODEL
    n = lambda k, shp, s: jax.random.normal(k, shp, jnp.float32) * s
    return {
        "x": n(ks[0], (BATCH, SEQ, D), 1.0),
        "c": n(ks[1], (BATCH, D), 1.0),
        "w_ada": n(ks[2], (L, D, N_MOD * D), 0.3 * D ** -0.5),
        "b_ada": n(ks[3], (L, N_MOD * D), 0.01),
        "g_norm1": 1.0 + n(ks[4], (L, D), 0.05),
        "w_in": n(ks[5], (L, D, IN_WIDTH), D ** -0.5),
        "dw_w": n(ks[6], (L, CONV_KERNEL, CONV_WIDTH), CONV_KERNEL ** -0.5),
        "dw_b": n(ks[7], (L, CONV_WIDTH), 0.01),
        "conv_ln_g": 1.0 + n(ks[8], (L, CONV_WIDTH), 0.05),
        "conv_ln_b": n(ks[9], (L, CONV_WIDTH), 0.01),
        "w_conv_pw": n(ks[10], (L, CONV_WIDTH, CONV_WIDTH), CONV_WIDTH ** -0.5),
        "w_pool_group": n(ks[11], (L, POOL_GROUPS, POOL_GROUP_DIM, POOL_GROUP_DIM), POOL_GROUP_DIM ** -0.5),
        "pool_scale": 1.0 + n(ks[12], (L, POOL_WIDTH), 0.1),
        "w_out": n(ks[13], (L, MIX_WIDTH, D), MIX_WIDTH ** -0.5),
        "g_norm2": 1.0 + n(ks[14], (L, D), 0.05),
        "w_ffn_gate": n(ks[15], (L, D, D_FF), D ** -0.5),
        "w_ffn_up": n(ks[16], (L, D, D_FF), D ** -0.5),
        "w_ffn_down": n(ks[17], (L, D_FF, D), D_FF ** -0.5),
        "g_final": 1.0 + n(ks[18], (D,), 0.05),
    }


def reference(x, c, w_ada, b_ada, g_norm1, w_in, dw_w, dw_b, conv_ln_g, conv_ln_b,
              w_conv_pw, w_pool_group, pool_scale, w_out, g_norm2,
              w_ffn_gate, w_ffn_up, w_ffn_down, g_final):
    c_act = jax.nn.silu(c)
    for l in range(DEPTH):
        mod = c_act @ w_ada[l] + b_ada[l]
        sh1, sc1, gt1, sh2, sc2, gt2 = [m[:, None, :] for m in jnp.split(mod, N_MOD, axis=-1)]

        h = rmsnorm(x, g_norm1[l]) * (1 + sc1) + sh1
        u = h @ w_in[l]
        u_conv = u[..., :2 * CONV_WIDTH]
        u_pool = u[..., 2 * CONV_WIDTH:]
        y_conv = conv_mixer(u_conv, dw_w[l], dw_b[l], conv_ln_g[l], conv_ln_b[l], w_conv_pw[l])
        y_pool = pool_mixer(u_pool, w_pool_group[l], pool_scale[l])
        y = jnp.concatenate([y_conv, y_pool], axis=-1) @ w_out[l]
        x = x + gt1 * y

        h = rmsnorm(x, g_norm2[l]) * (1 + sc2) + sh2
        f = (jax.nn.silu(h @ w_ffn_gate[l]) * (h @ w_ffn_up[l])) @ w_ffn_down[l]
        x = x + gt2 * f
    return rmsnorm(x, g_final)
```

```cpp
#include <hip/hip_runtime.h>
#include <hip/hip_cooperative_groups.h>
#include <cstdio>
#include <cstdint>
namespace cg = cooperative_groups;
namespace pg8 {
#define PG8_LAS __attribute__((address_space(3)))
typedef unsigned short bf16_t;
typedef short bf16x8 __attribute__((ext_vector_type(8)));
typedef float f32x4 __attribute__((ext_vector_type(4)));
typedef unsigned u32x4 __attribute__((ext_vector_type(4)));
constexpr int BM = 256, BK = 64, HALF = 128, HTB = HALF * BK * 2  , STAGE_BYTES = 8 * HTB, NXCD = 8, WGM = 8;

__host__ __device__ __forceinline__ int lds_byte(int r, int c) { const int st = (r >> 4) * 2 + (c >> 5), rr = r & 15, cc = c & 31, ob = rr * 64 + cc * 2; return st * 1024 + (ob ^ (((ob >> 9) & 1) << 5)); }
__host__ __device__ __forceinline__ void stage_rc(int b, int& R, int& C) { const int st = b / 1024, sb = b % 1024, swz = sb ^ (((sb >> 9) & 1) << 5); R = (st >> 1) * 16 + swz / 64; C = (st & 1) * 32 + (swz % 64) / 2; }
__host__ __device__ __forceinline__ int perm32(int rho) { const int n = rho >> 4, i = rho & 15; return 8 * (i >> 2) + 4 * n + (i & 3); }

struct Unit { int pm, pn; };
struct Gemm { const bf16_t* A; const bf16_t* Bt; int lda, ldb, K; };

struct StaticOrder {
    int nM, nN, nwg, G, c;
    __host__ __device__ void init(int M, int N, int G_, int c_) { nM = M / BM; nN = N / BM; nwg = nM * nN; G = G_; c = c_; }
    __host__ __device__ bool next(int i, Unit& u) const {
        const long L = (long)i * G + c; if (L >= nwg) return false;
        int wgid = (int)L; { const int q = nwg / NXCD, r = nwg % NXCD, xcd = wgid % NXCD, off = wgid / NXCD; wgid = (xcd < r ? xcd * (q + 1) : r * (q + 1) + (xcd - r) * q) + off; }
        const int nig = WGM * nN, gid = wgid / nig, fm = gid * WGM, gsz = (nM - fm) < WGM ? (nM - fm) : WGM;
        u.pm = fm + ((wgid % nig) % gsz); u.pn = (wgid % nig) / gsz; return true;
    }
    __device__ __forceinline__ void a_ready(const Unit&) const {}
    __device__ __forceinline__ void done(const Unit&) const {}
};

__device__ __forceinline__ unsigned cvt_pk_bf16(float lo, float hi) { unsigned r; asm volatile("v_cvt_pk_bf16_f32 %0, %1, %2" : "=v"(r) : "v"(lo), "v"(hi)); return r; }
__device__ __forceinline__ float sigmoidf_(float v) { return __builtin_amdgcn_rcpf(1.0f + __expf(-v)); }

template <int MODE> struct EpiPair {
    static constexpr bool PERM = true, AFTER_DRAIN = false;
    bf16_t* O; int ldc; int npair;
    __device__ __forceinline__ void operator()(const f32x4 (&acc)[2][2][4][2], const Unit& u, int wr, int wc, int fr, int fq) const {
        const int row0 = u.pm * BM + wr * 64 + fr;
        if (u.pn < npair) {
            const int col0 = u.pn * HALF + wc * 32 + 8 * fq;
#pragma unroll
            for (int ai = 0; ai < 2; ++ai)
#pragma unroll
                for (int m = 0; m < 4; ++m) { bf16_t* rowp = O + (size_t)(row0 + ai * HALF + m * 16) * ldc + col0;
                    float r[8];
#pragma unroll
                    for (int n = 0; n < 2; ++n)
#pragma unroll
                        for (int j = 0; j < 4; ++j) { const float a = acc[ai][0][m][n][j], b = acc[ai][1][m][n][j];
                            r[n * 4 + j] = (MODE == 0) ? a * sigmoidf_(b) : a * sigmoidf_(a) * b; }
                    u32x4 w; w.x = cvt_pk_bf16(r[0], r[1]); w.y = cvt_pk_bf16(r[2], r[3]); w.z = cvt_pk_bf16(r[4], r[5]); w.w = cvt_pk_bf16(r[6], r[7]);
                    *(u32x4*)rowp = w; }
        } else {
            const int col0 = npair * HALF + (u.pn - npair) * BM + wc * 32 + 8 * fq;
#pragma unroll
            for (int ai = 0; ai < 2; ++ai)
#pragma unroll
                for (int m = 0; m < 4; ++m) { bf16_t* rowp = O + (size_t)(row0 + ai * HALF + m * 16) * ldc + col0;
#pragma unroll
                    for (int bj = 0; bj < 2; ++bj) { const f32x4 v0 = acc[ai][bj][m][0], v1 = acc[ai][bj][m][1];
                        u32x4 w; w.x = cvt_pk_bf16(v0[0], v0[1]); w.y = cvt_pk_bf16(v0[2], v0[3]); w.z = cvt_pk_bf16(v1[0], v1[1]); w.w = cvt_pk_bf16(v1[2], v1[3]);
                        *(u32x4*)(rowp + bj * HALF) = w; } }
        }
    }
};
struct EpiRes {
    static constexpr bool PERM = false, AFTER_DRAIN = false;
    const float* base; float* out; const float* gate; int gate_ld; int rows_per_batch;
    __device__ __forceinline__ void operator()(const f32x4 (&acc)[2][2][4][2], const Unit& u, int wr, int wc, int fr, int fq) const {
        const int b = (u.pm * BM) / rows_per_batch;
        const float* gp = gate + (size_t)b * gate_ld;
        const int col0 = u.pn * BM + wc * 32 + 4 * fq;
        f32x4 gv[2][2];
#pragma unroll
        for (int bj = 0; bj < 2; ++bj)
#pragma unroll
            for (int n = 0; n < 2; ++n) gv[bj][n] = *(const f32x4*)(gp + col0 + bj * HALF + n * 16);
#pragma unroll
        for (int ai = 0; ai < 2; ++ai)
#pragma unroll
            for (int m = 0; m < 4; ++m) { const size_t off = (size_t)(u.pm * BM + ai * HALF + wr * 64 + m * 16 + fr) * 1024 + col0;
#pragma unroll
                for (int bj = 0; bj < 2; ++bj)
#pragma unroll
                    for (int n = 0; n < 2; ++n) { const f32x4 bs = *(const f32x4*)(base + off + bj * HALF + n * 16);
                        *(f32x4*)(out + off + bj * HALF + n * 16) = bs + gv[bj][n] * acc[ai][bj][m][n]; } }
    }
};
struct SmallOrder {
    int c, c0, nu, nN;
    __device__ __forceinline__ bool next(int i, Unit& u) const { const int idx = c - c0; if (i != 0 || idx < 0 || idx >= nu) return false; u.pm = idx / nN; u.pn = idx % nN; return true; }
    __device__ __forceinline__ void a_ready(const Unit&) const {}
    __device__ __forceinline__ void done(const Unit&) const {}
};

template <class Epi, class Sched, bool ALIGN_EPI = false, bool SP2 = false>
__device__ __forceinline__ void gemm_phase(PG8_LAS unsigned char* lds, const Gemm g, const Sched& S, const Epi& E) {
    const int tid = threadIdx.x, wid = __builtin_amdgcn_readfirstlane(tid >> 6), lane = tid & 63, wr = wid >> 2, wc = wid & 3, fr = lane & 15, fq = lane >> 4;
    const int K = g.K, nt = K / BK;
    unsigned voffA[2], voffB[2];
#pragma unroll
    for (int i = 0; i < 2; ++i) { int R, C; stage_rc(tid * 16 + i * 8192, R, C); const int Rb = Epi::PERM ? ((R & ~31) + perm32(R & 31)) : R;
        voffA[i] = (unsigned)(R * g.lda + C) * 2u; voffB[i] = (unsigned)(Rb * g.ldb + C) * 2u; }
    const size_t kstep = (size_t)(BK * 2);
    const size_t hstepA = (size_t)HALF * g.lda * 2, hstepB = (size_t)HALF * g.ldb * 2;
    const size_t tstepA = 2 * hstepA, tstepB = 2 * hstepB;
    const unsigned ldsw = (unsigned)wid * 1024u;
    const int aoff = lds_byte(wr * 64 + fr, fq * 8), boff = lds_byte(wc * 32 + fr, fq * 8);
#define PG8_SA(b, h) (((b) * 2 + (h)) * HTB)
#define PG8_SB(b, h) ((4 + (b) * 2 + (h)) * HTB)
#define PG8_STAGE(bufoff, gbase, voff) do { _Pragma("unroll") for (int _i = 0; _i < 2; ++_i) \
        __builtin_amdgcn_global_load_lds((const unsigned*)((const char*)(gbase) + (voff)[_i]), (PG8_LAS unsigned*)(lds + (bufoff) + ldsw + _i * 8192), 16, 0, 0); } while (0)
#define PG8_LDA(dst, b, h) do { _Pragma("unroll") for (int m = 0; m < 4; ++m) _Pragma("unroll") for (int k = 0; k < 2; ++k) dst[m][k] = *(const PG8_LAS bf16x8*)(lds + PG8_SA(b, h) + aoff + m * 2048 + k * 1024); } while (0)
#define PG8_LDB(dst, b, h) do { _Pragma("unroll") for (int n = 0; n < 2; ++n) _Pragma("unroll") for (int k = 0; k < 2; ++k) dst[n][k] = *(const PG8_LAS bf16x8*)(lds + PG8_SB(b, h) + boff + n * 2048 + k * 1024); } while (0)
#define PG8_MMA(ai, bj, At, Bt) do { __builtin_amdgcn_s_setprio(1); _Pragma("unroll") for (int m = 0; m < 4; ++m) _Pragma("unroll") for (int n = 0; n < 2; ++n) _Pragma("unroll") for (int k = 0; k < 2; ++k) \
        acc[ai][bj][m][n] = __builtin_amdgcn_mfma_f32_16x16x32_bf16(Bt[n][k], At[m][k], acc[ai][bj][m][n], 0, 0, 0); __builtin_amdgcn_s_setprio(0); } while (0)
#define PG8_WAIT_V(n) asm volatile("s_waitcnt vmcnt(" #n ")" ::: "memory")
#define PG8_WAIT_L(n) asm volatile("s_waitcnt lgkmcnt(" #n ")" ::: "memory")
#define PG8_BAR __builtin_amdgcn_s_barrier()
#define PG8_SCHED __builtin_amdgcn_sched_barrier(0)
    Unit cur, nxt; int ui = 0;
    if (!S.next(0, cur)) return;
    f32x4 acc[2][2][4][2];
#pragma unroll
    for (int a = 0; a < 2; ++a)
#pragma unroll
        for (int b = 0; b < 2; ++b)
#pragma unroll
            for (int m = 0; m < 4; ++m)
#pragma unroll
                for (int n = 0; n < 2; ++n) acc[a][b][m][n] = (f32x4){0.f, 0.f, 0.f, 0.f};
    bf16x8 At[4][2], B0[2][2], B1[2][2];
    const char* cA = (const char*)g.A + (size_t)cur.pm * tstepA; const char* cB = (const char*)g.Bt + (size_t)cur.pn * tstepB;
    S.a_ready(cur);
    if constexpr (SP2) {
        PG8_STAGE(PG8_SB(0, 0), cB, voffB); PG8_STAGE(PG8_SB(0, 1), cB + hstepB, voffB); PG8_STAGE(PG8_SA(0, 0), cA, voffA); PG8_STAGE(PG8_SA(0, 1), cA + hstepA, voffA);
        if (wr == 1) PG8_BAR;
        PG8_WAIT_V(2); PG8_BAR;
        PG8_STAGE(PG8_SB(1, 0), cB + kstep, voffB); PG8_STAGE(PG8_SA(1, 0), cA + kstep, voffA); PG8_STAGE(PG8_SB(1, 1), cB + hstepB + kstep, voffB);
        PG8_WAIT_V(6); PG8_BAR;
    } else {
        PG8_STAGE(PG8_SB(0, 0), cB, voffB); PG8_STAGE(PG8_SA(0, 0), cA, voffA); PG8_STAGE(PG8_SB(0, 1), cB + hstepB, voffB); PG8_STAGE(PG8_SA(0, 1), cA + hstepA, voffA);
        if (wr == 1) PG8_BAR;
        PG8_WAIT_V(4); PG8_BAR;
        PG8_STAGE(PG8_SB(1, 0), cB + kstep, voffB); PG8_STAGE(PG8_SA(1, 0), cA + kstep, voffA); PG8_STAGE(PG8_SB(1, 1), cB + hstepB + kstep, voffB);
        PG8_WAIT_V(6); PG8_BAR;
    }
    for (;;) {
        const bool has_next = S.next(ui + 1, nxt);
        const char* nA = has_next ? (const char*)g.A + (size_t)nxt.pm * tstepA : cA; const char* nB = has_next ? (const char*)g.Bt + (size_t)nxt.pn * tstepB : cB;
        for (int t = 0; t < nt; t += 2) {
            const bool last = (t == nt - 2);
            const char* a1 = cA + (size_t)(t + 1) * kstep;
            const char* a2 = last ? nA : cA + (size_t)(t + 2) * kstep; const char* b2 = last ? nB : cB + (size_t)(t + 2) * kstep;
            const char* a3 = a2 + kstep; const char* b3 = b2 + kstep;
            if (last && has_next) S.a_ready(nxt);
            if constexpr (SP2) {
            PG8_LDB(B0, 0, 0); PG8_LDB(B1, 0, 1); PG8_SCHED; PG8_LDA(At, 0, 0); PG8_STAGE(PG8_SA(1, 1), a1 + hstepA, voffA);
            PG8_WAIT_V(8); PG8_WAIT_L(0); PG8_BAR; PG8_MMA(0, 0, At, B0); PG8_MMA(0, 1, At, B1); PG8_BAR; PG8_SCHED;
            PG8_LDA(At, 0, 1); PG8_STAGE(PG8_SB(0, 0), b2, voffB); PG8_STAGE(PG8_SB(0, 1), b2 + hstepB, voffB); PG8_STAGE(PG8_SA(0, 0), a2, voffA);
            PG8_WAIT_V(8); PG8_WAIT_L(0); PG8_BAR; PG8_MMA(1, 0, At, B0); PG8_MMA(1, 1, At, B1); PG8_BAR; PG8_SCHED;
            PG8_LDB(B0, 1, 0); PG8_LDB(B1, 1, 1); PG8_SCHED; PG8_LDA(At, 1, 0); PG8_STAGE(PG8_SA(0, 1), a2 + hstepA, voffA);
            PG8_WAIT_V(8); PG8_WAIT_L(0); PG8_BAR; PG8_MMA(0, 0, At, B0); PG8_MMA(0, 1, At, B1); PG8_BAR; PG8_SCHED;
            PG8_LDA(At, 1, 1); PG8_STAGE(PG8_SB(1, 0), b3, voffB); PG8_STAGE(PG8_SB(1, 1), b3 + hstepB, voffB); PG8_STAGE(PG8_SA(1, 0), a3, voffA);
            PG8_WAIT_V(8); PG8_WAIT_L(0); PG8_BAR; PG8_MMA(1, 0, At, B0); PG8_MMA(1, 1, At, B1); PG8_BAR; PG8_SCHED;
            } else {
            PG8_LDB(B0, 0, 0); PG8_SCHED; PG8_LDA(At, 0, 0); PG8_STAGE(PG8_SA(1, 1), a1 + hstepA, voffA);
            PG8_WAIT_L(8); PG8_BAR; PG8_WAIT_L(0); PG8_MMA(0, 0, At, B0); PG8_BAR; PG8_SCHED;
            PG8_LDB(B1, 0, 1); PG8_STAGE(PG8_SB(0, 0), b2, voffB);
            PG8_BAR; PG8_WAIT_L(0); PG8_MMA(0, 1, At, B1); PG8_BAR;
            PG8_LDA(At, 0, 1); PG8_STAGE(PG8_SA(0, 0), a2, voffA);
            PG8_BAR; PG8_WAIT_L(0); PG8_MMA(1, 0, At, B0); PG8_BAR; PG8_SCHED;
            PG8_STAGE(PG8_SB(0, 1), b2 + hstepB, voffB);
            PG8_WAIT_V(6); PG8_BAR; PG8_MMA(1, 1, At, B1); PG8_BAR;
            PG8_LDB(B0, 1, 0); PG8_SCHED; PG8_LDA(At, 1, 0); PG8_STAGE(PG8_SA(0, 1), a2 + hstepA, voffA);
            PG8_WAIT_L(8); PG8_BAR; PG8_WAIT_L(0); PG8_MMA(0, 0, At, B0); PG8_BAR; PG8_SCHED;
            PG8_LDB(B1, 1, 1); PG8_STAGE(PG8_SB(1, 0), b3, voffB);
            PG8_BAR; PG8_WAIT_L(0); PG8_MMA(0, 1, At, B1); PG8_BAR;
            PG8_LDA(At, 1, 1); PG8_STAGE(PG8_SA(1, 0), a3, voffA);
            PG8_BAR; PG8_WAIT_L(0); PG8_MMA(1, 0, At, B0); PG8_BAR; PG8_SCHED;
            PG8_STAGE(PG8_SB(1, 1), b3 + hstepB, voffB);
            PG8_WAIT_V(6); PG8_BAR; PG8_MMA(1, 1, At, B1); PG8_BAR;
            }
        }
        if constexpr (ALIGN_EPI) { if (wr == 0) PG8_BAR; }
        if constexpr (!Epi::AFTER_DRAIN) { E(acc, cur, wr, wc, fr, fq); S.done(cur); }
        if (!has_next) break;
#pragma unroll
        for (int a = 0; a < 2; ++a)
#pragma unroll
            for (int b = 0; b < 2; ++b)
#pragma unroll
                for (int m = 0; m < 4; ++m)
#pragma unroll
                    for (int n = 0; n < 2; ++n) acc[a][b][m][n] = (f32x4){0.f, 0.f, 0.f, 0.f};
        cur = nxt; cA = nA; cB = nB; ++ui;
        if constexpr (ALIGN_EPI) { if (wr == 1) PG8_BAR; }
    }
    PG8_WAIT_V(0);
    if constexpr (!ALIGN_EPI) { if (wr == 0) PG8_BAR; }
    PG8_BAR;
    if constexpr (Epi::AFTER_DRAIN) { E.fused(acc, cur, wr, wc, fr, fq, lds, wid, lane); S.done(cur); }
#undef PG8_SA
#undef PG8_SB
#undef PG8_STAGE
#undef PG8_LDA
#undef PG8_LDB
#undef PG8_MMA
#undef PG8_WAIT_V
#undef PG8_WAIT_L
#undef PG8_BAR
#undef PG8_SCHED
}
}
constexpr int NWAVES = 8, NTHR = 512;
constexpr int BATCH = 8, SEQ = 2048, D = 1024, M = BATCH * SEQ;
constexpr int CW = 512, INW = 1536, FF = 2816, KCONV = 31, MODW = 6 * D;
constexpr float EPS = 1e-6f;
constexpr size_t MiB = 1u << 20;
constexpr size_t WS_ADA = 1 * MiB;
constexpr size_t WS_MOD = 3 * MiB;
constexpr size_t WS_WIN = 4 * MiB;
constexpr size_t WS_WPW = 7 * MiB;
constexpr size_t WS_WPOOL = 7 * MiB + 512 * 1024;
constexpr size_t WS_WO = 8 * MiB;
constexpr size_t WS_WEFF = 10 * MiB;
constexpr size_t WS_WGU = 12 * MiB;
constexpr size_t WS_WD = 24 * MiB;
constexpr size_t WS_H = 32 * MiB;
constexpr size_t WS_U = 64 * MiB;
constexpr size_t WS_A3 = 96 * MiB;
constexpr size_t WS_HFF = 64 * MiB;
constexpr size_t WS_END = 152 * MiB;
constexpr int LDS_BYTES = 147456;

#define LAS __attribute__((address_space(3)))
typedef unsigned short bf16;
typedef unsigned v4u __attribute__((ext_vector_type(4)));
typedef unsigned v2u __attribute__((ext_vector_type(2)));
typedef float f32x4 __attribute__((ext_vector_type(4)));
typedef float f32x2 __attribute__((ext_vector_type(2)));
#define LDS_WAIT() asm volatile("s_waitcnt lgkmcnt(0)" ::: "memory")
__device__ __forceinline__ unsigned f2bf(float f) { unsigned u = __builtin_bit_cast(unsigned, f); return (u + 0x7fffu + ((u >> 16) & 1u)) >> 16; }
__device__ __forceinline__ unsigned pk2(float lo, float hi) { return f2bf(lo) | (f2bf(hi) << 16); }
__device__ __forceinline__ float bf_lo(unsigned u) { return __builtin_bit_cast(float, u << 16); }
__device__ __forceinline__ float bf_hi(unsigned u) { return __builtin_bit_cast(float, u & 0xffff0000u); }
__device__ __forceinline__ float wave_sum(float v) {
#pragma unroll
    for (int o = 1; o < 64; o <<= 1) v += __shfl_xor(v, o);
    return v;
}
__device__ __forceinline__ float silu_f(float v) { return v / (1.0f + __expf(-v)); }

struct Frame {
    LAS unsigned char* lds;
    int tid, lane, wave, G;
    const float *x, *c, *w_ada, *b_ada, *g1, *w_in, *dw_w, *dw_b, *ln_g, *ln_b, *w_pw, *w_pool, *pool_scale, *w_out, *g2, *w_gate, *w_up, *w_down, *g_final;
    float* out;
    float *ADA, *MOD;
    bf16 *WinT, *WpwB, *WpoolB, *WoT, *WeffT, *WguT, *WdT, *H, *U, *A3, *HFF;
};

__device__ __forceinline__ void transpose_item(const float* W, int ldw, bf16* WT, int ldt, int k0, int n0, int drow, LAS float* scr, int lane) {
#pragma unroll 8
    for (int i = 0; i < 32; ++i) { const int kk = 2 * i + (lane >> 5); scr[kk * 33 + (lane & 31)] = W[(size_t)(k0 + kk) * ldw + n0 + (lane & 31)]; }
    LDS_WAIT(); asm volatile("" ::: "memory");
    const int c = lane & 7;
#pragma unroll
    for (int j = 0; j < 4; ++j) { const int n = (lane >> 3) + 8 * j; const LAS float* s = scr + (8 * c) * 33 + n;
        v4u o; o.x = pk2(s[0 * 33], s[1 * 33]); o.y = pk2(s[2 * 33], s[3 * 33]); o.z = pk2(s[4 * 33], s[5 * 33]); o.w = pk2(s[6 * 33], s[7 * 33]);
        *(v4u*)(WT + (size_t)(drow + n) * ldt + k0 + 8 * c) = o; }
    LDS_WAIT(); asm volatile("" ::: "memory");
}
__device__ __forceinline__ void p0_phase(Frame& F) {
    const int tid = F.tid, lane = F.lane, wave = F.wave;
    {
        LAS float* cact = (LAS float*)F.lds;
        LAS float* red = (LAS float*)(F.lds + 4096);
        for (int it = blockIdx.x; it < 192; it += F.G) {
            const int cb = it % 24, kc = it / 24;
            __syncthreads();
            for (int i = tid; i < 8 * 128; i += NTHR) { const int b = i >> 7, kk = i & 127; cact[i] = silu_f(F.c[b * D + kc * 128 + kk]); }
            __syncthreads();
            f32x4 acc[8];
#pragma unroll
            for (int b = 0; b < 8; ++b) acc[b] = (f32x4){0.f, 0.f, 0.f, 0.f};
            const float* wp = F.w_ada + (size_t)(kc * 128 + wave * 16) * MODW + cb * 256 + lane * 4;
#pragma unroll
            for (int kk = 0; kk < 16; ++kk) { const f32x4 w = *(const f32x4*)(wp + (size_t)kk * MODW);
#pragma unroll
                for (int b = 0; b < 8; ++b) { const float ca = cact[b * 128 + wave * 16 + kk]; acc[b] += w * ca; } }
#pragma unroll
            for (int b = 0; b < 8; ++b) *(LAS f32x4*)(red + (wave * 8 + b) * 256 + lane * 4) = acc[b];
            __syncthreads();
            { const int b = tid >> 6, col = (tid & 63) * 4; f32x4 s = (f32x4){0.f, 0.f, 0.f, 0.f};
#pragma unroll
              for (int w = 0; w < 8; ++w) s += *(const LAS f32x4*)(red + (w * 8 + b) * 256 + col);
              *(f32x4*)(F.ADA + (size_t)(kc * 8 + b) * MODW + cb * 256 + col) = s; }
        }
        __syncthreads();
    }
    {
        LAS float* scr = (LAS float*)(F.lds + wave * 16384);
        const int gw = blockIdx.x * NWAVES + wave, NGW = F.G * NWAVES;
        constexpr int I_IN = 16 * 48, I_O = 16 * 32, I_G = 16 * 88, I_D = 44 * 32, NITEMS = I_IN + I_O + 2 * I_G + I_D;
        for (int it = gw; it < NITEMS; it += NGW) {
            int r = it;
            if (r < I_IN) { const int kb = r / 48, n0 = (r % 48) * 32;
                const int drow = n0 < 512 ? 256 * (n0 >> 7) + (n0 & 127) : (n0 < 1024 ? 256 * ((n0 - 512) >> 7) + 128 + (n0 & 127) : n0);
                transpose_item(F.w_in, INW, F.WinT, D, kb * 64, n0, drow, scr, lane); continue; }
            r -= I_IN;
            if (r < I_O) { const int kb = r / 32, n0 = (r % 32) * 32; transpose_item(F.w_out, D, F.WoT, D, kb * 64, n0, n0, scr, lane); continue; }
            r -= I_O;
            if (r < I_G) { const int kb = r / 88, n0 = (r % 88) * 32; transpose_item(F.w_gate, FF, F.WguT, D, kb * 64, n0, 256 * (n0 >> 7) + (n0 & 127), scr, lane); continue; }
            r -= I_G;
            if (r < I_G) { const int kb = r / 88, n0 = (r % 88) * 32; transpose_item(F.w_up, FF, F.WguT, D, kb * 64, n0, 256 * (n0 >> 7) + 128 + (n0 & 127), scr, lane); continue; }
            r -= I_G;
            { const int kb = r / 32, n0 = (r % 32) * 32; transpose_item(F.w_down, D, F.WdT, FF, kb * 64, n0, n0, scr, lane); }
        }
    }
    for (int i = blockIdx.x * NTHR + tid; i < 512 * 512 / 4; i += F.G * NTHR) {
        const f32x4 v = ((const f32x4*)F.w_pw)[i];
        v2u o; o.x = pk2(v[0], v[1]); o.y = pk2(v[2], v[3]); ((v2u*)F.WpwB)[i] = o;
        const int r = (4 * i) >> 9, col = (4 * i) & 511, g = r >> 7;
        v2u p; p.x = 0u; p.y = 0u;
        if ((col >> 7) == g) { const f32x4 wv = *(const f32x4*)(F.w_pool + (size_t)r * 128 + (col & 127)); const f32x4 sc = *(const f32x4*)(F.pool_scale + col);
            p.x = pk2(wv[0] * sc[0], wv[1] * sc[1]); p.y = pk2(wv[2] * sc[2], wv[3] * sc[3]); }
        ((v2u*)F.WpoolB)[i] = p;
    }
}

template <bool PARTIALS> __device__ __forceinline__ void norm_phase(Frame& F, const float* src, bf16* dst, const float* gvec, int sh_off, int sc_off) {
    const int tid = F.tid, lane = F.lane, wave = F.wave;
    LAS float* gm = (LAS float*)F.lds; LAS float* sh = gm + 1024;
    for (int ch = blockIdx.x; ch < M / 64; ch += F.G) {
        const int row0 = ch * 64, b = row0 / SEQ;
        __syncthreads();
        for (int k = tid; k < D; k += NTHR) {
            float s_sh, s_sc;
            if (PARTIALS) { s_sh = F.b_ada[sh_off + k]; s_sc = F.b_ada[sc_off + k];
#pragma unroll
                for (int kc = 0; kc < 8; ++kc) { s_sh += F.ADA[(size_t)(kc * 8 + b) * MODW + sh_off + k]; s_sc += F.ADA[(size_t)(kc * 8 + b) * MODW + sc_off + k]; } }
            else { s_sh = F.MOD[b * MODW + sh_off + k]; s_sc = F.MOD[b * MODW + sc_off + k]; }
            gm[k] = gvec[k] * (1.0f + s_sc); sh[k] = s_sh; }
        __syncthreads();
        for (int r = wave; r < 64; r += NWAVES) {
            const f32x4* xr = (const f32x4*)(src + (size_t)(row0 + r) * D) + lane;
            f32x4 v[4]; float s = 0.f;
#pragma unroll
            for (int j = 0; j < 4; ++j) { v[j] = xr[64 * j]; s += (v[j][0] * v[j][0] + v[j][1] * v[j][1]) + (v[j][2] * v[j][2] + v[j][3] * v[j][3]); }
            const float rstd = 1.0f / sqrtf(wave_sum(s) * (1.0f / D) + EPS);
            v2u* o8 = (v2u*)(dst + (size_t)(row0 + r) * D) + lane;
#pragma unroll
            for (int j = 0; j < 4; ++j) { const f32x4 g4 = *(const LAS f32x4*)(gm + 4 * lane + 256 * j), s4 = *(const LAS f32x4*)(sh + 4 * lane + 256 * j);
                const f32x4 o = v[j] * rstd * g4 + s4; v2u w; w.x = pk2(o[0], o[1]); w.y = pk2(o[2], o[3]); o8[64 * j] = w; }
        }
    }
    __syncthreads();
}
__device__ __forceinline__ void final_norm_phase(Frame& F) {
    const int lane = F.lane; const int gw = blockIdx.x * NWAVES + F.wave, NGW = F.G * NWAVES;
    f32x4 g4[4];
#pragma unroll
    for (int j = 0; j < 4; ++j) g4[j] = *((const f32x4*)F.g_final + lane + 64 * j);
    for (int m = gw; m < M; m += NGW) {
        f32x4* xr = (f32x4*)(F.out + (size_t)m * D) + lane;
        f32x4 v[4]; float s = 0.f;
#pragma unroll
        for (int j = 0; j < 4; ++j) { v[j] = xr[64 * j]; s += (v[j][0] * v[j][0] + v[j][1] * v[j][1]) + (v[j][2] * v[j][2] + v[j][3] * v[j][3]); }
        const float rstd = 1.0f / sqrtf(wave_sum(s) * (1.0f / D) + EPS);
#pragma unroll
        for (int j = 0; j < 4; ++j) xr[64 * j] = v[j] * rstd * g4[j];
    }
}

__device__ __forceinline__ void mixer_phase(Frame& F) {
    const int tid = F.tid, lane = F.lane, wave = F.wave;
    LAS unsigned char* lds = F.lds;
    const int cp = tid & 255, half = tid >> 8;
    f32x2 w[KCONV];
#pragma unroll
    for (int j = 0; j < KCONV; ++j) w[j] = *(const f32x2*)(F.dw_w + j * CW + 2 * cp);
    const f32x2 bias = *(const f32x2*)(F.dw_b + 2 * cp);
    const f32x4 lg0 = *(const f32x4*)(F.ln_g + 4 * lane), lg1 = *(const f32x4*)(F.ln_g + 256 + 4 * lane);
    const f32x4 lb0 = *(const f32x4*)(F.ln_b + 4 * lane), lb1 = *(const f32x4*)(F.ln_b + 256 + 4 * lane);
    for (int tile = blockIdx.x; tile < M / 64; tile += F.G) {
        const int t0 = tile * 64, s0 = t0 & (SEQ - 1);
        __syncthreads();
        for (int r = wave; r < 94; r += NWAVES) {
            v4u v = (v4u){0u, 0u, 0u, 0u};
            if (s0 - 30 + r >= 0) v = *(const v4u*)(F.U + (size_t)(t0 - 30 + r) * D + lane * 8);
            *(LAS v4u*)(lds + r * 1024 + lane * 16) = v;
        }
        __syncthreads();
        f32x2 o[32];
#pragma unroll
        for (int q = 0; q < 4; ++q) {
            f32x2 a[8];
#pragma unroll
            for (int i = 0; i < 8; ++i) a[i] = bias;
#pragma unroll
            for (int r = 0; r < 38; ++r) {
                const unsigned u = *(const LAS unsigned*)(lds + (32 * half + 8 * q + r) * 1024 + cp * 4);
                const f32x2 xin = (f32x2){bf_lo(u), bf_hi(u)};
#pragma unroll
                for (int i = 0; i < 8; ++i) { const int j = r - i; if (j >= 0 && j < KCONV) a[i] += w[j] * xin; }
            }
#pragma unroll
            for (int i = 0; i < 8; ++i) o[8 * q + i] = a[i];
        }
        __syncthreads();
#pragma unroll
        for (int i = 0; i < 32; ++i) *(LAS f32x2*)(lds + (32 * half + i) * 2048 + cp * 8) = o[i];
        __syncthreads();
#pragma unroll 2
        for (int i = 0; i < 8; ++i) {
            const int tl = wave * 8 + i;
            const f32x4 v0 = *(const LAS f32x4*)(lds + tl * 2048 + lane * 16), v1 = *(const LAS f32x4*)(lds + tl * 2048 + 1024 + lane * 16);
            const float mean = wave_sum((v0[0] + v0[1]) + (v0[2] + v0[3]) + (v1[0] + v1[1]) + (v1[2] + v1[3])) * (1.0f / CW);
            const f32x4 d0 = v0 - mean, d1 = v1 - mean;
            const float var = wave_sum((d0[0] * d0[0] + d0[1] * d0[1]) + (d0[2] * d0[2] + d0[3] * d0[3]) + (d1[0] * d1[0] + d1[1] * d1[1]) + (d1[2] * d1[2] + d1[3] * d1[3])) * (1.0f / CW);
            const float rstd = 1.0f / sqrtf(var + EPS);
            const f32x4 y0 = d0 * rstd * lg0 + lb0, y1 = d1 * rstd * lg1 + lb1;
            v2u p0, p1;
            p0.x = pk2(silu_f(y0[0]), silu_f(y0[1])); p0.y = pk2(silu_f(y0[2]), silu_f(y0[3]));
            p1.x = pk2(silu_f(y1[0]), silu_f(y1[1])); p1.y = pk2(silu_f(y1[2]), silu_f(y1[3]));
            bf16* orow = F.A3 + (size_t)(t0 + tl) * D;
            *(v2u*)(orow + 4 * lane) = p0; *(v2u*)(orow + 256 + 4 * lane) = p1;
        }
        __syncthreads();
        for (int r = wave; r < 79; r += NWAVES) {
            v4u v = (v4u){0u, 0u, 0u, 0u};
            if (s0 - 15 + r >= 0) v = *(const v4u*)(F.U + (size_t)(t0 - 15 + r) * D + 512 + lane * 8);
            *(LAS v4u*)(lds + r * 1024 + lane * 16) = v;
        }
        __syncthreads();
        {
            const int win = 2 << (cp >> 6);
            for (int i = 0; i < 32; ++i) {
                const int tl = 32 * half + i, s = s0 + tl;
                float sx = 0.f, sy = 0.f;
                for (int k = 0; k < win; ++k) { const unsigned u = *(const LAS unsigned*)(lds + (tl + 15 - k) * 1024 + cp * 4); sx += bf_lo(u); sy += bf_hi(u); }
                const unsigned uc = *(const LAS unsigned*)(lds + (tl + 15) * 1024 + cp * 4);
                const float inv = 1.0f / (float)((s + 1) < win ? (s + 1) : win);
                *(unsigned*)(F.A3 + (size_t)(t0 + tl) * D + 512 + 2 * cp) = pk2(sx * inv - bf_lo(uc), sy * inv - bf_hi(uc));
            }
        }
    }
    __syncthreads();
}

struct Args { const float* in[19]; float* out; unsigned char* ws; int ph_lo, ph_hi; };
constexpr int N_PHASES = 9;
__global__ void __launch_bounds__(NTHR, 2) fwd_megakernel(Args args) {
    extern __shared__ __attribute__((aligned(16))) unsigned char lds_raw[];
    cg::grid_group grid = cg::this_grid();
    Frame F;
    F.lds = (LAS unsigned char*)lds_raw;
    F.tid = threadIdx.x; F.lane = F.tid & 63; F.wave = __builtin_amdgcn_readfirstlane(F.tid >> 6); F.G = gridDim.x;
    F.x = args.in[0]; F.c = args.in[1]; F.w_ada = args.in[2]; F.b_ada = args.in[3]; F.g1 = args.in[4]; F.w_in = args.in[5]; F.dw_w = args.in[6]; F.dw_b = args.in[7];
    F.ln_g = args.in[8]; F.ln_b = args.in[9]; F.w_pw = args.in[10]; F.w_pool = args.in[11]; F.pool_scale = args.in[12]; F.w_out = args.in[13]; F.g2 = args.in[14];
    F.w_gate = args.in[15]; F.w_up = args.in[16]; F.w_down = args.in[17]; F.g_final = args.in[18]; F.out = args.out;
    unsigned char* ws = args.ws;
    F.ADA = (float*)(ws + WS_ADA); F.MOD = (float*)(ws + WS_MOD);
    F.WinT = (bf16*)(ws + WS_WIN); F.WpwB = (bf16*)(ws + WS_WPW); F.WpoolB = (bf16*)(ws + WS_WPOOL); F.WoT = (bf16*)(ws + WS_WO); F.WeffT = (bf16*)(ws + WS_WEFF);
    F.WguT = (bf16*)(ws + WS_WGU); F.WdT = (bf16*)(ws + WS_WD); F.H = (bf16*)(ws + WS_H); F.U = (bf16*)(ws + WS_U); F.A3 = (bf16*)(ws + WS_A3); F.HFF = (bf16*)(ws + WS_HFF);
    const int lo = args.ph_lo, hi = args.ph_hi;
#define IN(k) (lo <= (k) && (k) < hi)
#define SEAM(k) do { if (IN(k) && IN((k) + 1)) grid.sync(); } while (0)

    if (IN(0)) { p0_phase(F); } SEAM(0);
    if (IN(1)) {
        for (int i = blockIdx.x * NTHR + F.tid; i < BATCH * MODW; i += F.G * NTHR) { float s = F.b_ada[i % MODW];
#pragma unroll
            for (int kc = 0; kc < 8; ++kc) s += F.ADA[(size_t)kc * BATCH * MODW + i];
            F.MOD[i] = s; }
        norm_phase<true>(F, F.x, F.H, F.g1, 0, D);
    } SEAM(1);
    if (IN(2)) {
        { pg8::Gemm g{F.H, F.WinT, D, D, D}; pg8::StaticOrder S; S.init(M, INW, F.G, (int)blockIdx.x);
          pg8::EpiPair<0> E{F.U, D, 4};
          pg8::gemm_phase<pg8::EpiPair<0>, pg8::StaticOrder, true, true>(F.lds, g, S, E); }
        { pg8::Gemm g{F.WoT, F.WpwB, D, 512, 512}; pg8::SmallOrder S{(int)blockIdx.x, F.G - 16, 8, 2};
          pg8::EpiPair<0> E{F.WeffT, D, 0};
          pg8::gemm_phase<pg8::EpiPair<0>, pg8::SmallOrder, true, true>(F.lds, g, S, E); }
        { pg8::Gemm g{F.WoT + 512, F.WpoolB, D, 512, 512}; pg8::SmallOrder S{(int)blockIdx.x, F.G - 8, 8, 2};
          pg8::EpiPair<0> E{F.WeffT + 512, D, 0};
          pg8::gemm_phase<pg8::EpiPair<0>, pg8::SmallOrder, true, true>(F.lds, g, S, E); }
    } SEAM(2);
    if (IN(3)) { mixer_phase(F); } SEAM(3);
    if (IN(4)) {
        pg8::Gemm g{F.A3, F.WeffT, D, D, D}; pg8::StaticOrder S; S.init(M, D, F.G, (int)blockIdx.x);
        pg8::EpiRes E{F.x, F.out, F.MOD + 2 * D, MODW, SEQ};
        pg8::gemm_phase<pg8::EpiRes, pg8::StaticOrder, true, true>(F.lds, g, S, E);
    } SEAM(4);
    if (IN(5)) { norm_phase<false>(F, F.out, F.H, F.g2, 3 * D, 4 * D); } SEAM(5);
    if (IN(6)) {
        pg8::Gemm g{F.H, F.WguT, D, D, D}; pg8::StaticOrder S; S.init(M, 2 * FF, F.G, (int)blockIdx.x);
        pg8::EpiPair<1> E{F.HFF, FF, 22};
        pg8::gemm_phase<pg8::EpiPair<1>, pg8::StaticOrder, true, true>(F.lds, g, S, E);
    } SEAM(6);
    if (IN(7)) {
        pg8::Gemm g{F.HFF, F.WdT, FF, FF, FF}; pg8::StaticOrder S; S.init(M, D, F.G, (int)blockIdx.x);
        pg8::EpiRes E{F.out, F.out, F.MOD + 5 * D, MODW, SEQ};
        pg8::gemm_phase<pg8::EpiRes, pg8::StaticOrder, true, true>(F.lds, g, S, E);
    } SEAM(7);
    if (IN(8)) { final_norm_phase(F); }
#undef IN
#undef SEAM
}

#ifndef MK_N_LAUNCHES
#define MK_N_LAUNCHES 1
#endif
extern "C" void kernel_launch(void* const* d_in, const int* in_sizes, int n_in, void* d_out, int out_size, void* d_ws, size_t ws_size, hipStream_t stream) {
    static int grid = 0;
    if (grid == 0) {
        if (n_in != 19 || in_sizes[0] != M * D || out_size != M * D || ws_size < WS_END) { fprintf(stderr, "kernel_launch: unexpected shapes (n_in %d, in0 %d, out %d, ws %zu)\n", n_in, n_in > 0 ? in_sizes[0] : -1, out_size, ws_size); grid = -1; return; }
        int dev = 0, cus = 0, per_cu = 0;
        if (hipGetDevice(&dev) != hipSuccess || hipDeviceGetAttribute(&cus, hipDeviceAttributeMultiprocessorCount, dev) != hipSuccess) { grid = -1; return; }
        if (hipFuncSetAttribute((const void*)fwd_megakernel, hipFuncAttributeMaxDynamicSharedMemorySize, LDS_BYTES) != hipSuccess) { fprintf(stderr, "kernel_launch: hipFuncSetAttribute failed\n"); grid = -1; return; }
        if (hipOccupancyMaxActiveBlocksPerMultiprocessor(&per_cu, (const void*)fwd_megakernel, NTHR, LDS_BYTES) != hipSuccess || per_cu < 1) { fprintf(stderr, "kernel_launch: occupancy query gave %d\n", per_cu); per_cu = 1; }
        (void)hipGetLastError();
        grid = cus * 1;
        if (grid < 16) grid = -1;
    }
    if (grid < 0) return;
    Args a{};
    for (int i = 0; i < 19; ++i) a.in[i] = (const float*)d_in[i];
    a.out = (float*)d_out; a.ws = (unsigned char*)d_ws;
#if MK_N_LAUNCHES == 1
    a.ph_lo = 0; a.ph_hi = N_PHASES;
    void* kargs[] = {&a};
    hipError_t e = hipLaunchCooperativeKernel((const void*)fwd_megakernel, dim3(grid), dim3(NTHR), kargs, LDS_BYTES, stream);
    if (e != hipSuccess) fprintf(stderr, "kernel_launch: cooperative launch failed: %s (grid %d)\n", hipGetErrorString(e), grid);
#else
    for (int p = 0; p < N_PHASES; ++p) { a.ph_lo = p; a.ph_hi = p + 1; hipLaunchKernelGGL(fwd_megakernel, dim3(grid), dim3(NTHR), LDS_BYTES, stream, a); }
#endif
}
```

```cpp
#include <hip/hip_runtime.h>
#include <hip/hip_cooperative_groups.h>
#include <cstdio>
#include <cstdint>
namespace cg = cooperative_groups;
#define PROBE 0
namespace pg8 {
#define PG8_LAS __attribute__((address_space(3)))
typedef unsigned short bf16_t;
typedef short bf16x8 __attribute__((ext_vector_type(8)));
typedef float f32x4 __attribute__((ext_vector_type(4)));
typedef unsigned u32x4 __attribute__((ext_vector_type(4)));
constexpr int BM = 256, BK = 64, HALF = 128, HTB = HALF * BK * 2  , STAGE_BYTES = 8 * HTB, NXCD = 8, WGM = 8;

__host__ __device__ __forceinline__ int lds_byte(int r, int c) { const int st = (r >> 4) * 2 + (c >> 5), rr = r & 15, cc = c & 31, ob = rr * 64 + cc * 2; return st * 1024 + (ob ^ (((ob >> 9) & 1) << 5)); }
__host__ __device__ __forceinline__ void stage_rc(int b, int& R, int& C) { const int st = b / 1024, sb = b % 1024, swz = sb ^ (((sb >> 9) & 1) << 5); R = (st >> 1) * 16 + swz / 64; C = (st & 1) * 32 + (swz % 64) / 2; }
__host__ __device__ __forceinline__ int perm32(int rho) { const int n = rho >> 4, i = rho & 15; return 8 * (i >> 2) + 4 * n + (i & 3); }

struct Unit { int pm, pn; };
struct Gemm { const bf16_t* A; const bf16_t* Bt; int lda, ldb, K; };

struct StaticOrder {
    int nM, nN, nwg, G, c, rep;
    __host__ __device__ void init(int M, int N, int G_, int c_) { nM = M / BM; nN = N / BM; nwg = nM * nN; G = G_; c = c_; rep = 1; }
    __host__ __device__ bool next(int i, Unit& u) const {
        const long L = (long)i * G + c; if (L >= (long)nwg * rep) return false;
        int wgid = (int)(L % nwg); { const int q = nwg / NXCD, r = nwg % NXCD, xcd = wgid % NXCD, off = wgid / NXCD; wgid = (xcd < r ? xcd * (q + 1) : r * (q + 1) + (xcd - r) * q) + off; }
        const int nig = WGM * nN, gid = wgid / nig, fm = gid * WGM, gsz = (nM - fm) < WGM ? (nM - fm) : WGM;
        u.pm = fm + ((wgid % nig) % gsz); u.pn = (wgid % nig) / gsz; return true;
    }
    __device__ __forceinline__ void a_ready(const Unit&) const {}
    __device__ __forceinline__ void done(const Unit&) const {}
};

__device__ __forceinline__ unsigned cvt_pk_bf16(float lo, float hi) { unsigned r; asm volatile("v_cvt_pk_bf16_f32 %0, %1, %2" : "=v"(r) : "v"(lo), "v"(hi)); return r; }
__device__ __forceinline__ float sigmoidf_(float v) { return __builtin_amdgcn_rcpf(1.0f + __expf(-v)); }

template <int MODE> struct EpiPair {
    static constexpr bool PERM = true, AFTER_DRAIN = false;
    bf16_t* O; int ldc; int npair;
    __device__ __forceinline__ void operator()(const f32x4 (&acc)[2][2][4][2], const Unit& u, int wr, int wc, int fr, int fq) const {
        const int row0 = u.pm * BM + wr * 64 + fr;
        if (u.pn < npair) {
            const int col0 = u.pn * HALF + wc * 32 + 8 * fq;
#pragma unroll
            for (int ai = 0; ai < 2; ++ai)
#pragma unroll
                for (int m = 0; m < 4; ++m) { bf16_t* rowp = O + (size_t)(row0 + ai * HALF + m * 16) * ldc + col0;
                    float r[8];
#pragma unroll
                    for (int n = 0; n < 2; ++n)
#pragma unroll
                        for (int j = 0; j < 4; ++j) { const float a = acc[ai][0][m][n][j], b = acc[ai][1][m][n][j];
                            r[n * 4 + j] = (MODE == 0) ? a * sigmoidf_(b) : a * sigmoidf_(a) * b; }
                    u32x4 w; w.x = cvt_pk_bf16(r[0], r[1]); w.y = cvt_pk_bf16(r[2], r[3]); w.z = cvt_pk_bf16(r[4], r[5]); w.w = cvt_pk_bf16(r[6], r[7]);
                    *(u32x4*)rowp = w; }
        } else {
            const int col0 = npair * HALF + (u.pn - npair) * BM + wc * 32 + 8 * fq;
#pragma unroll
            for (int ai = 0; ai < 2; ++ai)
#pragma unroll
                for (int m = 0; m < 4; ++m) { bf16_t* rowp = O + (size_t)(row0 + ai * HALF + m * 16) * ldc + col0;
#pragma unroll
                    for (int bj = 0; bj < 2; ++bj) { const f32x4 v0 = acc[ai][bj][m][0], v1 = acc[ai][bj][m][1];
                        u32x4 w; w.x = cvt_pk_bf16(v0[0], v0[1]); w.y = cvt_pk_bf16(v0[2], v0[3]); w.z = cvt_pk_bf16(v1[0], v1[1]); w.w = cvt_pk_bf16(v1[2], v1[3]);
                        *(u32x4*)(rowp + bj * HALF) = w; } }
        }
    }
};
struct EpiRes {
    static constexpr bool PERM = false, AFTER_DRAIN = false;
    const float* base; float* out; const float* gate; int gate_ld; int rows_per_batch;
    __device__ __forceinline__ void operator()(const f32x4 (&acc)[2][2][4][2], const Unit& u, int wr, int wc, int fr, int fq) const {
        const int b = (u.pm * BM) / rows_per_batch;
        const float* gp = gate + (size_t)b * gate_ld;
        const int col0 = u.pn * BM + wc * 32 + 4 * fq;
        f32x4 gv[2][2];
#pragma unroll
        for (int bj = 0; bj < 2; ++bj)
#pragma unroll
            for (int n = 0; n < 2; ++n) gv[bj][n] = *(const f32x4*)(gp + col0 + bj * HALF + n * 16);
#pragma unroll
        for (int ai = 0; ai < 2; ++ai)
#pragma unroll
            for (int m = 0; m < 4; ++m) { const size_t off = (size_t)(u.pm * BM + ai * HALF + wr * 64 + m * 16 + fr) * 1024 + col0;
#pragma unroll
                for (int bj = 0; bj < 2; ++bj)
#pragma unroll
                    for (int n = 0; n < 2; ++n) { const f32x4 bs = *(const f32x4*)(base + off + bj * HALF + n * 16);
                        *(f32x4*)(out + off + bj * HALF + n * 16) = bs + gv[bj][n] * acc[ai][bj][m][n]; } }
    }
};
struct SmallOrder {
    int c, c0, nu, nN;
    __device__ __forceinline__ bool next(int i, Unit& u) const { const int idx = c - c0; if (i != 0 || idx < 0 || idx >= nu) return false; u.pm = idx / nN; u.pn = idx % nN; return true; }
    __device__ __forceinline__ void a_ready(const Unit&) const {}
    __device__ __forceinline__ void done(const Unit&) const {}
};

template <class Epi, class Sched, bool ALIGN_EPI = false, bool SP2 = false>
__device__ __forceinline__ void gemm_phase(PG8_LAS unsigned char* lds, const Gemm g, const Sched& S, const Epi& E) {
    const int tid = threadIdx.x, wid = __builtin_amdgcn_readfirstlane(tid >> 6), lane = tid & 63, wr = wid >> 2, wc = wid & 3, fr = lane & 15, fq = lane >> 4;
    const int K = g.K, nt = K / BK;
    unsigned voffA[2], voffB[2];
#pragma unroll
    for (int i = 0; i < 2; ++i) { int R, C; stage_rc(tid * 16 + i * 8192, R, C); const int Rb = Epi::PERM ? ((R & ~31) + perm32(R & 31)) : R;
        voffA[i] = (unsigned)(R * g.lda + C) * 2u; voffB[i] = (unsigned)(Rb * g.ldb + C) * 2u; }
    const size_t kstep = (size_t)(BK * 2);
    const size_t hstepA = (size_t)HALF * g.lda * 2, hstepB = (size_t)HALF * g.ldb * 2;
    const size_t tstepA = 2 * hstepA, tstepB = 2 * hstepB;
    const unsigned ldsw = (unsigned)wid * 1024u;
    const int aoff = lds_byte(wr * 64 + fr, fq * 8), boff = lds_byte(wc * 32 + fr, fq * 8);
#define PG8_SA(b, h) (((b) * 2 + (h)) * HTB)
#define PG8_SB(b, h) ((4 + (b) * 2 + (h)) * HTB)
#define PG8_STAGE(bufoff, gbase, voff) do { _Pragma("unroll") for (int _i = 0; _i < 2; ++_i) \
        __builtin_amdgcn_global_load_lds((const unsigned*)((const char*)(gbase) + (voff)[_i]), (PG8_LAS unsigned*)(lds + (bufoff) + ldsw + _i * 8192), 16, 0, 0); } while (0)
#define PG8_LDA(dst, b, h) do { _Pragma("unroll") for (int m = 0; m < 4; ++m) _Pragma("unroll") for (int k = 0; k < 2; ++k) dst[m][k] = *(const PG8_LAS bf16x8*)(lds + PG8_SA(b, h) + aoff + m * 2048 + k * 1024); } while (0)
#define PG8_LDB(dst, b, h) do { _Pragma("unroll") for (int n = 0; n < 2; ++n) _Pragma("unroll") for (int k = 0; k < 2; ++k) dst[n][k] = *(const PG8_LAS bf16x8*)(lds + PG8_SB(b, h) + boff + n * 2048 + k * 1024); } while (0)
#define PG8_MMA(ai, bj, At, Bt) do { __builtin_amdgcn_s_setprio(1); _Pragma("unroll") for (int m = 0; m < 4; ++m) _Pragma("unroll") for (int n = 0; n < 2; ++n) _Pragma("unroll") for (int k = 0; k < 2; ++k) \
        acc[ai][bj][m][n] = __builtin_amdgcn_mfma_f32_16x16x32_bf16(Bt[n][k], At[m][k], acc[ai][bj][m][n], 0, 0, 0); __builtin_amdgcn_s_setprio(0); } while (0)
#define PG8_WAIT_V(n) asm volatile("s_waitcnt vmcnt(" #n ")" ::: "memory")
#define PG8_WAIT_L(n) asm volatile("s_waitcnt lgkmcnt(" #n ")" ::: "memory")
#define PG8_BAR __builtin_amdgcn_s_barrier()
#define PG8_SCHED __builtin_amdgcn_sched_barrier(0)
    Unit cur, nxt; int ui = 0;
    if (!S.next(0, cur)) return;
    f32x4 acc[2][2][4][2];
#pragma unroll
    for (int a = 0; a < 2; ++a)
#pragma unroll
        for (int b = 0; b < 2; ++b)
#pragma unroll
            for (int m = 0; m < 4; ++m)
#pragma unroll
                for (int n = 0; n < 2; ++n) acc[a][b][m][n] = (f32x4){0.f, 0.f, 0.f, 0.f};
    bf16x8 At[4][2], B0[2][2], B1[2][2];
    const char* cA = (const char*)g.A + (size_t)cur.pm * tstepA; const char* cB = (const char*)g.Bt + (size_t)cur.pn * tstepB;
    S.a_ready(cur);
    if constexpr (SP2) {
        PG8_STAGE(PG8_SB(0, 0), cB, voffB); PG8_STAGE(PG8_SB(0, 1), cB + hstepB, voffB); PG8_STAGE(PG8_SA(0, 0), cA, voffA); PG8_STAGE(PG8_SA(0, 1), cA + hstepA, voffA);
        if (wr == 1) PG8_BAR;
        PG8_WAIT_V(2); PG8_BAR;
        PG8_STAGE(PG8_SB(1, 0), cB + kstep, voffB); PG8_STAGE(PG8_SA(1, 0), cA + kstep, voffA); PG8_STAGE(PG8_SB(1, 1), cB + hstepB + kstep, voffB);
        PG8_WAIT_V(6); PG8_BAR;
    } else {
        PG8_STAGE(PG8_SB(0, 0), cB, voffB); PG8_STAGE(PG8_SA(0, 0), cA, voffA); PG8_STAGE(PG8_SB(0, 1), cB + hstepB, voffB); PG8_STAGE(PG8_SA(0, 1), cA + hstepA, voffA);
        if (wr == 1) PG8_BAR;
        PG8_WAIT_V(4); PG8_BAR;
        PG8_STAGE(PG8_SB(1, 0), cB + kstep, voffB); PG8_STAGE(PG8_SA(1, 0), cA + kstep, voffA); PG8_STAGE(PG8_SB(1, 1), cB + hstepB + kstep, voffB);
        PG8_WAIT_V(6); PG8_BAR;
    }
    for (;;) {
        const bool has_next = S.next(ui + 1, nxt);
        const char* nA = has_next ? (const char*)g.A + (size_t)nxt.pm * tstepA : cA; const char* nB = has_next ? (const char*)g.Bt + (size_t)nxt.pn * tstepB : cB;
        for (int t = 0; t < nt; t += 2) {
            const bool last = (t == nt - 2);
            const char* a1 = cA + (size_t)(t + 1) * kstep;
            const char* a2 = last ? nA : cA + (size_t)(t + 2) * kstep; const char* b2 = last ? nB : cB + (size_t)(t + 2) * kstep;
            const char* a3 = a2 + kstep; const char* b3 = b2 + kstep;
            if (last && has_next) S.a_ready(nxt);
            if constexpr (SP2) {
            PG8_LDB(B0, 0, 0); PG8_LDB(B1, 0, 1); PG8_SCHED; PG8_LDA(At, 0, 0); PG8_STAGE(PG8_SA(1, 1), a1 + hstepA, voffA);
            PG8_WAIT_V(8); PG8_WAIT_L(0); PG8_BAR; PG8_MMA(0, 0, At, B0); PG8_MMA(0, 1, At, B1); PG8_BAR; PG8_SCHED;
            PG8_LDA(At, 0, 1); PG8_STAGE(PG8_SB(0, 0), b2, voffB); PG8_STAGE(PG8_SB(0, 1), b2 + hstepB, voffB); PG8_STAGE(PG8_SA(0, 0), a2, voffA);
            PG8_WAIT_V(8); PG8_WAIT_L(0); PG8_BAR; PG8_MMA(1, 0, At, B0); PG8_MMA(1, 1, At, B1); PG8_BAR; PG8_SCHED;
            PG8_LDB(B0, 1, 0); PG8_LDB(B1, 1, 1); PG8_SCHED; PG8_LDA(At, 1, 0); PG8_STAGE(PG8_SA(0, 1), a2 + hstepA, voffA);
            PG8_WAIT_V(8); PG8_WAIT_L(0); PG8_BAR; PG8_MMA(0, 0, At, B0); PG8_MMA(0, 1, At, B1); PG8_BAR; PG8_SCHED;
            PG8_LDA(At, 1, 1); PG8_STAGE(PG8_SB(1, 0), b3, voffB); PG8_STAGE(PG8_SB(1, 1), b3 + hstepB, voffB); PG8_STAGE(PG8_SA(1, 0), a3, voffA);
            PG8_WAIT_V(8); PG8_WAIT_L(0); PG8_BAR; PG8_MMA(1, 0, At, B0); PG8_MMA(1, 1, At, B1); PG8_BAR; PG8_SCHED;
            } else {
            PG8_LDB(B0, 0, 0); PG8_SCHED; PG8_LDA(At, 0, 0); PG8_STAGE(PG8_SA(1, 1), a1 + hstepA, voffA);
            PG8_WAIT_L(8); PG8_BAR; PG8_WAIT_L(0); PG8_MMA(0, 0, At, B0); PG8_BAR; PG8_SCHED;
            PG8_LDB(B1, 0, 1); PG8_STAGE(PG8_SB(0, 0), b2, voffB);
            PG8_BAR; PG8_WAIT_L(0); PG8_MMA(0, 1, At, B1); PG8_BAR;
            PG8_LDA(At, 0, 1); PG8_STAGE(PG8_SA(0, 0), a2, voffA);
            PG8_BAR; PG8_WAIT_L(0); PG8_MMA(1, 0, At, B0); PG8_BAR; PG8_SCHED;
            PG8_STAGE(PG8_SB(0, 1), b2 + hstepB, voffB);
            PG8_WAIT_V(6); PG8_BAR; PG8_MMA(1, 1, At, B1); PG8_BAR;
            PG8_LDB(B0, 1, 0); PG8_SCHED; PG8_LDA(At, 1, 0); PG8_STAGE(PG8_SA(0, 1), a2 + hstepA, voffA);
            PG8_WAIT_L(8); PG8_BAR; PG8_WAIT_L(0); PG8_MMA(0, 0, At, B0); PG8_BAR; PG8_SCHED;
            PG8_LDB(B1, 1, 1); PG8_STAGE(PG8_SB(1, 0), b3, voffB);
            PG8_BAR; PG8_WAIT_L(0); PG8_MMA(0, 1, At, B1); PG8_BAR;
            PG8_LDA(At, 1, 1); PG8_STAGE(PG8_SA(1, 0), a3, voffA);
            PG8_BAR; PG8_WAIT_L(0); PG8_MMA(1, 0, At, B0); PG8_BAR; PG8_SCHED;
            PG8_STAGE(PG8_SB(1, 1), b3 + hstepB, voffB);
            PG8_WAIT_V(6); PG8_BAR; PG8_MMA(1, 1, At, B1); PG8_BAR;
            }
        }
        if constexpr (ALIGN_EPI) { if (wr == 0) PG8_BAR; }
        if constexpr (!Epi::AFTER_DRAIN) { E(acc, cur, wr, wc, fr, fq); S.done(cur); }
        if (!has_next) break;
#pragma unroll
        for (int a = 0; a < 2; ++a)
#pragma unroll
            for (int b = 0; b < 2; ++b)
#pragma unroll
                for (int m = 0; m < 4; ++m)
#pragma unroll
                    for (int n = 0; n < 2; ++n) acc[a][b][m][n] = (f32x4){0.f, 0.f, 0.f, 0.f};
        cur = nxt; cA = nA; cB = nB; ++ui;
        if constexpr (ALIGN_EPI) { if (wr == 1) PG8_BAR; }
    }
    PG8_WAIT_V(0);
    if constexpr (!ALIGN_EPI) { if (wr == 0) PG8_BAR; }
    PG8_BAR;
    if constexpr (Epi::AFTER_DRAIN) { E.fused(acc, cur, wr, wc, fr, fq, lds, wid, lane); S.done(cur); }
#undef PG8_SA
#undef PG8_SB
#undef PG8_STAGE
#undef PG8_LDA
#undef PG8_LDB
#undef PG8_MMA
#undef PG8_WAIT_V
#undef PG8_WAIT_L
#undef PG8_BAR
#undef PG8_SCHED
}
}
constexpr int NWAVES = 8, NTHR = 512;
constexpr int BATCH = 8, SEQ = 2048, D = 1024, M = BATCH * SEQ;
constexpr int CW = 512, INW = 1536, FF = 2816, KCONV = 31, MODW = 6 * D;
constexpr float EPS = 1e-6f;
constexpr size_t MiB = 1u << 20;
constexpr size_t WS_CTL = 0, CTL_ZERO_BYTES = 16384;
constexpr size_t WS_ADA = 1 * MiB;
constexpr size_t WS_MOD = 3 * MiB;
constexpr size_t WS_WIN = 4 * MiB;
constexpr size_t WS_WPW = 7 * MiB;
constexpr size_t WS_WPOOL = 7 * MiB + 512 * 1024;
constexpr size_t WS_WO = 8 * MiB;
constexpr size_t WS_WEFF = 10 * MiB;
constexpr size_t WS_WGU = 12 * MiB;
constexpr size_t WS_WD = 24 * MiB;
constexpr size_t WS_H = 32 * MiB;
constexpr size_t WS_U = 64 * MiB;
constexpr size_t WS_A3 = 96 * MiB;
constexpr size_t WS_HFF = 64 * MiB;
constexpr size_t WS_END = 152 * MiB;
constexpr int LDS_BYTES = 147456;

#define LAS __attribute__((address_space(3)))
typedef unsigned short bf16;
typedef unsigned v4u __attribute__((ext_vector_type(4)));
typedef unsigned v2u __attribute__((ext_vector_type(2)));
typedef float f32x4 __attribute__((ext_vector_type(4)));
typedef float f32x2 __attribute__((ext_vector_type(2)));
#define LDS_WAIT() asm volatile("s_waitcnt lgkmcnt(0)" ::: "memory")
__device__ __forceinline__ unsigned f2bf(float f) { unsigned u = __builtin_bit_cast(unsigned, f); return (u + 0x7fffu + ((u >> 16) & 1u)) >> 16; }
__device__ __forceinline__ unsigned pk2(float lo, float hi) { return f2bf(lo) | (f2bf(hi) << 16); }
__device__ __forceinline__ float bf_lo(unsigned u) { return __builtin_bit_cast(float, u << 16); }
__device__ __forceinline__ float bf_hi(unsigned u) { return __builtin_bit_cast(float, u & 0xffff0000u); }
__device__ __forceinline__ float wave_sum(float v) {
#pragma unroll
    for (int o = 1; o < 64; o <<= 1) v += __shfl_xor(v, o);
    return v;
}
__device__ __forceinline__ float silu_f(float v) { return v / (1.0f + __expf(-v)); }

struct Frame {
    LAS unsigned char* lds;
    int tid, lane, wave, G;
    const float *x, *c, *w_ada, *b_ada, *g1, *w_in, *dw_w, *dw_b, *ln_g, *ln_b, *w_pw, *w_pool, *pool_scale, *w_out, *g2, *w_gate, *w_up, *w_down, *g_final;
    float* out;
    float *ADA, *MOD;
    bf16 *WinT, *WpwB, *WpoolB, *WoT, *WeffT, *WguT, *WdT, *H, *U, *A3, *HFF;
};

__device__ __forceinline__ void transpose_item(const float* W, int ldw, bf16* WT, int ldt, int k0, int n0, int drow, LAS float* scr, int lane) {
#pragma unroll 8
    for (int i = 0; i < 32; ++i) { const int kk = 2 * i + (lane >> 5); scr[kk * 33 + (lane & 31)] = W[(size_t)(k0 + kk) * ldw + n0 + (lane & 31)]; }
    LDS_WAIT(); asm volatile("" ::: "memory");
    const int c = lane & 7;
#pragma unroll
    for (int j = 0; j < 4; ++j) { const int n = (lane >> 3) + 8 * j; const LAS float* s = scr + (8 * c) * 33 + n;
        v4u o; o.x = pk2(s[0 * 33], s[1 * 33]); o.y = pk2(s[2 * 33], s[3 * 33]); o.z = pk2(s[4 * 33], s[5 * 33]); o.w = pk2(s[6 * 33], s[7 * 33]);
        *(v4u*)(WT + (size_t)(drow + n) * ldt + k0 + 8 * c) = o; }
    LDS_WAIT(); asm volatile("" ::: "memory");
}
__device__ __forceinline__ void p0_phase(Frame& F) {
    const int tid = F.tid, lane = F.lane, wave = F.wave;
    {
        LAS float* cact = (LAS float*)F.lds;
        LAS float* red = (LAS float*)(F.lds + 4096);
        for (int it = blockIdx.x; it < 192; it += F.G) {
            const int cb = it % 24, kc = it / 24;
            __syncthreads();
            for (int i = tid; i < 8 * 128; i += NTHR) { const int b = i >> 7, kk = i & 127; cact[i] = silu_f(F.c[b * D + kc * 128 + kk]); }
            __syncthreads();
            f32x4 acc[8];
#pragma unroll
            for (int b = 0; b < 8; ++b) acc[b] = (f32x4){0.f, 0.f, 0.f, 0.f};
            const float* wp = F.w_ada + (size_t)(kc * 128 + wave * 16) * MODW + cb * 256 + lane * 4;
#pragma unroll
            for (int kk = 0; kk < 16; ++kk) { const f32x4 w = *(const f32x4*)(wp + (size_t)kk * MODW);
#pragma unroll
                for (int b = 0; b < 8; ++b) { const float ca = cact[b * 128 + wave * 16 + kk]; acc[b] += w * ca; } }
#pragma unroll
            for (int b = 0; b < 8; ++b) *(LAS f32x4*)(red + (wave * 8 + b) * 256 + lane * 4) = acc[b];
            __syncthreads();
            { const int b = tid >> 6, col = (tid & 63) * 4; f32x4 s = (f32x4){0.f, 0.f, 0.f, 0.f};
#pragma unroll
              for (int w = 0; w < 8; ++w) s += *(const LAS f32x4*)(red + (w * 8 + b) * 256 + col);
              *(f32x4*)(F.ADA + (size_t)(kc * 8 + b) * MODW + cb * 256 + col) = s; }
        }
        __syncthreads();
    }
    {
        LAS float* scr = (LAS float*)(F.lds + wave * 16384);
        const int gw = blockIdx.x * NWAVES + wave, NGW = F.G * NWAVES;
        constexpr int I_IN = 16 * 48, I_O = 16 * 32, I_G = 16 * 88, I_D = 44 * 32, NITEMS = I_IN + I_O + 2 * I_G + I_D;
        for (int it = gw; it < NITEMS; it += NGW) {
            int r = it;
            if (r < I_IN) { const int kb = r / 48, n0 = (r % 48) * 32;
                const int drow = n0 < 512 ? 256 * (n0 >> 7) + (n0 & 127) : (n0 < 1024 ? 256 * ((n0 - 512) >> 7) + 128 + (n0 & 127) : n0);
                transpose_item(F.w_in, INW, F.WinT, D, kb * 64, n0, drow, scr, lane); continue; }
            r -= I_IN;
            if (r < I_O) { const int kb = r / 32, n0 = (r % 32) * 32; transpose_item(F.w_out, D, F.WoT, D, kb * 64, n0, n0, scr, lane); continue; }
            r -= I_O;
            if (r < I_G) { const int kb = r / 88, n0 = (r % 88) * 32; transpose_item(F.w_gate, FF, F.WguT, D, kb * 64, n0, 256 * (n0 >> 7) + (n0 & 127), scr, lane); continue; }
            r -= I_G;
            if (r < I_G) { const int kb = r / 88, n0 = (r % 88) * 32; transpose_item(F.w_up, FF, F.WguT, D, kb * 64, n0, 256 * (n0 >> 7) + 128 + (n0 & 127), scr, lane); continue; }
            r -= I_G;
            { const int kb = r / 32, n0 = (r % 32) * 32; transpose_item(F.w_down, D, F.WdT, FF, kb * 64, n0, n0, scr, lane); }
        }
    }
    for (int i = blockIdx.x * NTHR + tid; i < 512 * 512 / 4; i += F.G * NTHR) {
        const f32x4 v = ((const f32x4*)F.w_pw)[i];
        v2u o; o.x = pk2(v[0], v[1]); o.y = pk2(v[2], v[3]); ((v2u*)F.WpwB)[i] = o;
        const int r = (4 * i) >> 9, col = (4 * i) & 511, g = r >> 7;
        v2u p; p.x = 0u; p.y = 0u;
        if ((col >> 7) == g) { const f32x4 wv = *(const f32x4*)(F.w_pool + (size_t)r * 128 + (col & 127)); const f32x4 sc = *(const f32x4*)(F.pool_scale + col);
            p.x = pk2(wv[0] * sc[0], wv[1] * sc[1]); p.y = pk2(wv[2] * sc[2], wv[3] * sc[3]); }
        ((v2u*)F.WpoolB)[i] = p;
    }
}

template <bool PARTIALS> __device__ __forceinline__ void norm_phase(Frame& F, const float* src, bf16* dst, const float* gvec, int sh_off, int sc_off) {
    const int tid = F.tid, lane = F.lane, wave = F.wave;
    LAS float* gm = (LAS float*)F.lds; LAS float* sh = gm + 1024;
    for (int ch = blockIdx.x; ch < M / 64; ch += F.G) {
        const int row0 = ch * 64, b = row0 / SEQ;
        __syncthreads();
        for (int k = tid; k < D; k += NTHR) {
            float s_sh, s_sc;
            if (PARTIALS) { s_sh = F.b_ada[sh_off + k]; s_sc = F.b_ada[sc_off + k];
#pragma unroll
                for (int kc = 0; kc < 8; ++kc) { s_sh += F.ADA[(size_t)(kc * 8 + b) * MODW + sh_off + k]; s_sc += F.ADA[(size_t)(kc * 8 + b) * MODW + sc_off + k]; } }
            else { s_sh = F.MOD[b * MODW + sh_off + k]; s_sc = F.MOD[b * MODW + sc_off + k]; }
            gm[k] = gvec[k] * (1.0f + s_sc); sh[k] = s_sh; }
        __syncthreads();
        for (int r = wave; r < 64; r += NWAVES) {
            const f32x4* xr = (const f32x4*)(src + (size_t)(row0 + r) * D) + lane;
            f32x4 v[4]; float s = 0.f;
#pragma unroll
            for (int j = 0; j < 4; ++j) { v[j] = xr[64 * j]; s += (v[j][0] * v[j][0] + v[j][1] * v[j][1]) + (v[j][2] * v[j][2] + v[j][3] * v[j][3]); }
            const float rstd = 1.0f / sqrtf(wave_sum(s) * (1.0f / D) + EPS);
            v2u* o8 = (v2u*)(dst + (size_t)(row0 + r) * D) + lane;
#pragma unroll
            for (int j = 0; j < 4; ++j) { const f32x4 g4 = *(const LAS f32x4*)(gm + 4 * lane + 256 * j), s4 = *(const LAS f32x4*)(sh + 4 * lane + 256 * j);
                const f32x4 o = v[j] * rstd * g4 + s4; v2u w; w.x = pk2(o[0], o[1]); w.y = pk2(o[2], o[3]); o8[64 * j] = w; }
        }
    }
    __syncthreads();
}
__device__ __forceinline__ void final_norm_phase(Frame& F) {
    const int lane = F.lane; const int gw = blockIdx.x * NWAVES + F.wave, NGW = F.G * NWAVES;
    f32x4 g4[4];
#pragma unroll
    for (int j = 0; j < 4; ++j) g4[j] = *((const f32x4*)F.g_final + lane + 64 * j);
    for (int m = gw; m < M; m += NGW) {
        f32x4* xr = (f32x4*)(F.out + (size_t)m * D) + lane;
        f32x4 v[4]; float s = 0.f;
#pragma unroll
        for (int j = 0; j < 4; ++j) { v[j] = xr[64 * j]; s += (v[j][0] * v[j][0] + v[j][1] * v[j][1]) + (v[j][2] * v[j][2] + v[j][3] * v[j][3]); }
        const float rstd = 1.0f / sqrtf(wave_sum(s) * (1.0f / D) + EPS);
#pragma unroll
        for (int j = 0; j < 4; ++j) xr[64 * j] = v[j] * rstd * g4[j];
    }
}

__device__ __forceinline__ void mixer_phase(Frame& F) {
    const int tid = F.tid, lane = F.lane, wave = F.wave;
    LAS unsigned char* lds = F.lds;
    const int cp = tid & 255, half = tid >> 8;
    f32x2 w[KCONV];
#pragma unroll
    for (int j = 0; j < KCONV; ++j) w[j] = *(const f32x2*)(F.dw_w + j * CW + 2 * cp);
    const f32x2 bias = *(const f32x2*)(F.dw_b + 2 * cp);
    const f32x4 lg0 = *(const f32x4*)(F.ln_g + 4 * lane), lg1 = *(const f32x4*)(F.ln_g + 256 + 4 * lane);
    const f32x4 lb0 = *(const f32x4*)(F.ln_b + 4 * lane), lb1 = *(const f32x4*)(F.ln_b + 256 + 4 * lane);
    for (int tt_ = blockIdx.x; tt_ < (PROBE == 1 ? 2 : 1) * (M / 64); tt_ += F.G) { const int tile = tt_ % (M / 64);
        const int t0 = tile * 64, s0 = t0 & (SEQ - 1);
        __syncthreads();
        for (int r = wave; r < 94; r += NWAVES) {
            v4u v = (v4u){0u, 0u, 0u, 0u};
            if (s0 - 30 + r >= 0) v = *(const v4u*)(F.U + (size_t)(t0 - 30 + r) * D + lane * 8);
            *(LAS v4u*)(lds + r * 1024 + lane * 16) = v;
        }
        __syncthreads();
        f32x2 o[32];
#pragma unroll
        for (int q = 0; q < 4; ++q) {
            f32x2 a[8];
#pragma unroll
            for (int i = 0; i < 8; ++i) a[i] = bias;
#pragma unroll
            for (int r = 0; r < 38; ++r) {
                const unsigned u = *(const LAS unsigned*)(lds + (32 * half + 8 * q + r) * 1024 + cp * 4);
                const f32x2 xin = (f32x2){bf_lo(u), bf_hi(u)};
#pragma unroll
                for (int i = 0; i < 8; ++i) { const int j = r - i; if (j >= 0 && j < KCONV) a[i] += w[j] * xin; }
            }
#pragma unroll
            for (int i = 0; i < 8; ++i) o[8 * q + i] = a[i];
        }
        __syncthreads();
#pragma unroll
        for (int i = 0; i < 32; ++i) *(LAS f32x2*)(lds + (32 * half + i) * 2048 + cp * 8) = o[i];
        __syncthreads();
#pragma unroll 2
        for (int i = 0; i < 8; ++i) {
            const int tl = wave * 8 + i;
            const f32x4 v0 = *(const LAS f32x4*)(lds + tl * 2048 + lane * 16), v1 = *(const LAS f32x4*)(lds + tl * 2048 + 1024 + lane * 16);
            const float mean = wave_sum((v0[0] + v0[1]) + (v0[2] + v0[3]) + (v1[0] + v1[1]) + (v1[2] + v1[3])) * (1.0f / CW);
            const f32x4 d0 = v0 - mean, d1 = v1 - mean;
            const float var = wave_sum((d0[0] * d0[0] + d0[1] * d0[1]) + (d0[2] * d0[2] + d0[3] * d0[3]) + (d1[0] * d1[0] + d1[1] * d1[1]) + (d1[2] * d1[2] + d1[3] * d1[3])) * (1.0f / CW);
            const float rstd = 1.0f / sqrtf(var + EPS);
            const f32x4 y0 = d0 * rstd * lg0 + lb0, y1 = d1 * rstd * lg1 + lb1;
            v2u p0, p1;
            p0.x = pk2(silu_f(y0[0]), silu_f(y0[1])); p0.y = pk2(silu_f(y0[2]), silu_f(y0[3]));
            p1.x = pk2(silu_f(y1[0]), silu_f(y1[1])); p1.y = pk2(silu_f(y1[2]), silu_f(y1[3]));
            bf16* orow = F.A3 + (size_t)(t0 + tl) * D;
            *(v2u*)(orow + 4 * lane) = p0; *(v2u*)(orow + 256 + 4 * lane) = p1;
        }
        __syncthreads();
        for (int r = wave; r < 79; r += NWAVES) {
            v4u v = (v4u){0u, 0u, 0u, 0u};
            if (s0 - 15 + r >= 0) v = *(const v4u*)(F.U + (size_t)(t0 - 15 + r) * D + 512 + lane * 8);
            *(LAS v4u*)(lds + r * 1024 + lane * 16) = v;
        }
        __syncthreads();
        {
            const int win = 2 << (cp >> 6);
            for (int i = 0; i < 32; ++i) {
                const int tl = 32 * half + i, s = s0 + tl;
                float sx = 0.f, sy = 0.f;
                for (int k = 0; k < win; ++k) { const unsigned u = *(const LAS unsigned*)(lds + (tl + 15 - k) * 1024 + cp * 4); sx += bf_lo(u); sy += bf_hi(u); }
                const unsigned uc = *(const LAS unsigned*)(lds + (tl + 15) * 1024 + cp * 4);
                const float inv = 1.0f / (float)((s + 1) < win ? (s + 1) : win);
                *(unsigned*)(F.A3 + (size_t)(t0 + tl) * D + 512 + 2 * cp) = pk2(sx * inv - bf_lo(uc), sy * inv - bf_hi(uc));
            }
        }
    }
    __syncthreads();
}

#define XB_TMO      128
#define XB_XCNT(j)  (256  + 64 * (j))
#define XB_XSUB(j)  (1280 + 64 * (j))
#define XB_XGEN(j)  (2304 + 64 * (j))
#define XB_TOP      3328
#define XB_TOPGEN   3392
#define XCD_BAR_WORDS 3456
#define XB_SPIN_CAP (1u << 18)

__device__ __forceinline__ unsigned xb_ld(unsigned* p)              { return __hip_atomic_load(p, __ATOMIC_RELAXED, __HIP_MEMORY_SCOPE_AGENT); }
__device__ __forceinline__ unsigned xb_add(unsigned* p, unsigned v) { return __hip_atomic_fetch_add(p, v, __ATOMIC_RELAXED, __HIP_MEMORY_SCOPE_AGENT); }
__device__ __forceinline__ unsigned xb_xcc_id() { return (unsigned)__builtin_amdgcn_s_getreg((3 << 11) | 20) & 0xFu; }
#define XB_SPIN(cond, bar) do { unsigned _sp = 0; while (cond) { __builtin_amdgcn_s_sleep(1); \
    if ((++_sp & 255u) == 0u) { if (xb_ld(&(bar)[XB_TMO])) break; if (_sp > XB_SPIN_CAP) { atomicAdd(&(bar)[XB_TMO], 1u); break; } } } } while (0)

struct XcdBarrier {
    unsigned* bar; unsigned x;
    volatile LAS unsigned* st;
};

__device__ __forceinline__ XcdBarrier xcd_barrier_post(unsigned* bar, volatile LAS unsigned* st) {
    XcdBarrier b; b.bar = bar; b.x = xb_xcc_id(); b.st = st;
    if (threadIdx.x == 0) (void)xb_add(&bar[XB_XCNT(b.x)], 1u);
    return b;
}
__device__ __forceinline__ void xcd_barrier_complete(unsigned* bar, unsigned x, unsigned& nloc, unsigned& nx) {
    const unsigned G = gridDim.x * gridDim.y * gridDim.z;
    unsigned sum, cnt, mine, sp = 0u;
    for (;;) {
        sum = 0u; cnt = 0u; mine = 0u;
#pragma unroll
        for (unsigned j = 0; j < 16; ++j) { const unsigned c = xb_ld(&bar[XB_XCNT(j)]); sum += c; cnt += (c > 0u) ? 1u : 0u; mine = (j == x) ? c : mine; }
        if (sum == G) break;
        __builtin_amdgcn_s_sleep(1);
        if ((++sp & 255u) == 0u) { if (xb_ld(&bar[XB_TMO])) break; if (sp > XB_SPIN_CAP) { atomicAdd(&bar[XB_TMO], 1u); break; } }
    }
    nloc = mine > 0u ? mine : 1u; nx = cnt > 0u ? cnt : 1u;
}

__device__ __forceinline__ void xcd_barrier(const XcdBarrier& b) {
    asm volatile("s_waitcnt vmcnt(0)" ::: "memory");
    __syncthreads();
    if (threadIdx.x == 0) {
        unsigned* bar = b.bar;
        __builtin_amdgcn_s_waitcnt(0);
        unsigned nloc = b.st[0], nx = b.st[1];
        if (nloc == 0u) { xcd_barrier_complete(bar, b.x, nloc, nx); b.st[0] = nloc; b.st[1] = nx; }
        const unsigned old = xb_add(&bar[XB_XSUB(b.x)], 1u);
        const unsigned gen = old / nloc;
        if (old + 1u == (gen + 1u) * nloc) {
            __builtin_amdgcn_fence(__ATOMIC_RELEASE, "agent");
            asm volatile("s_waitcnt vmcnt(0)" ::: "memory");
            const unsigned og = xb_add(&bar[XB_TOP], 1u);
            const unsigned tg = og / nx;
            if (og + 1u == (tg + 1u) * nx) xb_add(&bar[XB_TOPGEN], 1u);
            else XB_SPIN(xb_ld(&bar[XB_TOPGEN]) == tg, bar);
            __builtin_amdgcn_fence(__ATOMIC_ACQUIRE, "agent");
            xb_add(&bar[XB_XGEN(b.x)], 1u);
            asm volatile("s_waitcnt vmcnt(0)" ::: "memory");
        } else {
            XB_SPIN(xb_ld(&bar[XB_XGEN(b.x)]) == gen, bar);
            __builtin_amdgcn_fence(__ATOMIC_ACQUIRE, "agent");
            asm volatile("s_waitcnt vmcnt(0)" ::: "memory");
        }
    }
    __syncthreads();
}

struct Args { const float* in[19]; float* out; unsigned char* ws; int ph_lo, ph_hi; };
constexpr int N_PHASES = 9;
__global__ void __launch_bounds__(NTHR, 2) fwd_megakernel(Args args) {
    extern __shared__ __attribute__((aligned(16))) unsigned char lds_raw[];
    cg::grid_group grid = cg::this_grid();
    Frame F;
    F.lds = (LAS unsigned char*)lds_raw;
    F.tid = threadIdx.x; F.lane = F.tid & 63; F.wave = __builtin_amdgcn_readfirstlane(F.tid >> 6); F.G = gridDim.x;
    F.x = args.in[0]; F.c = args.in[1]; F.w_ada = args.in[2]; F.b_ada = args.in[3]; F.g1 = args.in[4]; F.w_in = args.in[5]; F.dw_w = args.in[6]; F.dw_b = args.in[7];
    F.ln_g = args.in[8]; F.ln_b = args.in[9]; F.w_pw = args.in[10]; F.w_pool = args.in[11]; F.pool_scale = args.in[12]; F.w_out = args.in[13]; F.g2 = args.in[14];
    F.w_gate = args.in[15]; F.w_up = args.in[16]; F.w_down = args.in[17]; F.g_final = args.in[18]; F.out = args.out;
    unsigned char* ws = args.ws;
    F.ADA = (float*)(ws + WS_ADA); F.MOD = (float*)(ws + WS_MOD);
    F.WinT = (bf16*)(ws + WS_WIN); F.WpwB = (bf16*)(ws + WS_WPW); F.WpoolB = (bf16*)(ws + WS_WPOOL); F.WoT = (bf16*)(ws + WS_WO); F.WeffT = (bf16*)(ws + WS_WEFF);
    F.WguT = (bf16*)(ws + WS_WGU); F.WdT = (bf16*)(ws + WS_WD); F.H = (bf16*)(ws + WS_H); F.U = (bf16*)(ws + WS_U); F.A3 = (bf16*)(ws + WS_A3); F.HFF = (bf16*)(ws + WS_HFF);
    const int lo = args.ph_lo, hi = args.ph_hi;
    { volatile LAS unsigned* st0 = (volatile LAS unsigned*)(F.lds + 131072 + 64); if (F.tid < 4) st0[F.tid] = 0u; }
    __syncthreads();
    XcdBarrier bar = xcd_barrier_post((unsigned*)(ws + WS_CTL), (volatile LAS unsigned*)(F.lds + 131072 + 64));
    if (lo < 0) grid.sync();
#define IN(k) (lo <= (k) && (k) < hi)
#define SEAM(k) do { if (IN(k) && IN((k) + 1)) xcd_barrier(bar); } while (0)

    if (PROBE == 3) { for (int i_ = 0; i_ < 8; ++i_) xcd_barrier(bar); }
    if (IN(0)) { for (int rep_ = 0; rep_ < (PROBE == 2 ? 2 : 1); ++rep_) { p0_phase(F); __syncthreads(); } } SEAM(0);
    if (IN(1)) {
        for (int i = blockIdx.x * NTHR + F.tid; i < BATCH * MODW; i += F.G * NTHR) { float s = F.b_ada[i % MODW];
#pragma unroll
            for (int kc = 0; kc < 8; ++kc) s += F.ADA[(size_t)kc * BATCH * MODW + i];
            F.MOD[i] = s; }
        norm_phase<true>(F, F.x, F.H, F.g1, 0, D);
    } SEAM(1);
    if (IN(2)) {
        { pg8::Gemm g{F.H, F.WinT, D, D, D}; pg8::StaticOrder S; S.init(M, INW, F.G, (int)blockIdx.x);
          pg8::EpiPair<0> E{F.U, D, 4};
          pg8::gemm_phase<pg8::EpiPair<0>, pg8::StaticOrder, true, true>(F.lds, g, S, E); }
        { pg8::Gemm g{F.WoT, F.WpwB, D, 512, 512}; pg8::SmallOrder S{(int)blockIdx.x, F.G - 16, 8, 2};
          pg8::EpiPair<0> E{F.WeffT, D, 0};
          pg8::gemm_phase<pg8::EpiPair<0>, pg8::SmallOrder, true, true>(F.lds, g, S, E); }
        { pg8::Gemm g{F.WoT + 512, F.WpoolB, D, 512, 512}; pg8::SmallOrder S{(int)blockIdx.x, F.G - 8, 8, 2};
          pg8::EpiPair<0> E{F.WeffT + 512, D, 0};
          pg8::gemm_phase<pg8::EpiPair<0>, pg8::SmallOrder, true, true>(F.lds, g, S, E); }
    } SEAM(2);
    if (IN(3)) { mixer_phase(F); } SEAM(3);
    if (IN(4)) {
        pg8::Gemm g{F.A3, F.WeffT, D, D, D}; pg8::StaticOrder S; S.init(M, D, F.G, (int)blockIdx.x);
        pg8::EpiRes E{F.x, F.out, F.MOD + 2 * D, MODW, SEQ};
        pg8::gemm_phase<pg8::EpiRes, pg8::StaticOrder, true, true>(F.lds, g, S, E);
    } SEAM(4);
    if (IN(5)) { norm_phase<false>(F, F.out, F.H, F.g2, 3 * D, 4 * D); } SEAM(5);
    if (IN(6)) {
        pg8::Gemm g{F.H, F.WguT, D, D, D}; pg8::StaticOrder S; S.init(M, 2 * FF, F.G, (int)blockIdx.x);
        pg8::EpiPair<1> E{F.HFF, FF, 22};
        if (PROBE == 4) S.rep = 2;
        pg8::gemm_phase<pg8::EpiPair<1>, pg8::StaticOrder, true, true>(F.lds, g, S, E);
    } SEAM(6);
    if (IN(7)) {
        pg8::Gemm g{F.HFF, F.WdT, FF, FF, FF}; pg8::StaticOrder S; S.init(M, D, F.G, (int)blockIdx.x);
        pg8::EpiRes E{F.out, F.out, F.MOD + 5 * D, MODW, SEQ};
        pg8::gemm_phase<pg8::EpiRes, pg8::StaticOrder, true, true>(F.lds, g, S, E);
    } SEAM(7);
    if (IN(8)) { final_norm_phase(F); }
#undef IN
#undef SEAM
}

#ifndef MK_N_LAUNCHES
#define MK_N_LAUNCHES 1
#endif
extern "C" void kernel_launch(void* const* d_in, const int* in_sizes, int n_in, void* d_out, int out_size, void* d_ws, size_t ws_size, hipStream_t stream) {
    static int grid = 0;
    if (grid == 0) {
        if (n_in != 19 || in_sizes[0] != M * D || out_size != M * D || ws_size < WS_END) { fprintf(stderr, "kernel_launch: unexpected shapes (n_in %d, in0 %d, out %d, ws %zu)\n", n_in, n_in > 0 ? in_sizes[0] : -1, out_size, ws_size); grid = -1; return; }
        int dev = 0, cus = 0, per_cu = 0;
        if (hipGetDevice(&dev) != hipSuccess || hipDeviceGetAttribute(&cus, hipDeviceAttributeMultiprocessorCount, dev) != hipSuccess) { grid = -1; return; }
        if (hipFuncSetAttribute((const void*)fwd_megakernel, hipFuncAttributeMaxDynamicSharedMemorySize, LDS_BYTES) != hipSuccess) { fprintf(stderr, "kernel_launch: hipFuncSetAttribute failed\n"); grid = -1; return; }
        if (hipOccupancyMaxActiveBlocksPerMultiprocessor(&per_cu, (const void*)fwd_megakernel, NTHR, LDS_BYTES) != hipSuccess || per_cu < 1) { fprintf(stderr, "kernel_launch: occupancy query gave %d\n", per_cu); per_cu = 1; }
        (void)hipGetLastError();
        grid = cus * 1;
        if (grid < 16) grid = -1;
    }
    if (grid < 0) return;
    if (hipMemsetAsync((char*)d_ws + WS_CTL, 0, CTL_ZERO_BYTES, stream) != hipSuccess) { fprintf(stderr, "kernel_launch: memset failed\n"); return; }
    Args a{};
    for (int i = 0; i < 19; ++i) a.in[i] = (const float*)d_in[i];
    a.out = (float*)d_out; a.ws = (unsigned char*)d_ws;
#if MK_N_LAUNCHES == 1
    a.ph_lo = 0; a.ph_hi = N_PHASES;
    void* kargs[] = {&a};
    hipError_t e = hipLaunchCooperativeKernel((const void*)fwd_megakernel, dim3(grid), dim3(NTHR), kargs, LDS_BYTES, stream);
    if (e != hipSuccess) fprintf(stderr, "kernel_launch: cooperative launch failed: %s (grid %d)\n", hipGetErrorString(e), grid);
#else
    for (int p = 0; p < N_PHASES; ++p) { a.ph_lo = p; a.ph_hi = p + 1; hipLaunchKernelGGL(fwd_megakernel, dim3(grid), dim3(NTHR), LDS_BYTES, stream, a); }
#endif
}
```
